# Optimizing an MI355X kernel written in HIP

```python
import jax, jax.numpy as jnp
from jax import lax
import numpy as np

D_MODEL = 2048
BATCH = 4
SEQ = 2048
DEPTH = 4
DEC_BATCH = 128
DEC_SEQ = 4
PAST_LEN = 16384
PAGE_SIZE = 128

POOL_WINDOWS = (2, 4, 8, 16)
N_POOL_GROUPS = len(POOL_WINDOWS)
POOL_GROUP = D_MODEL // 16
POOL_WIDTH = N_POOL_GROUPS * POOL_GROUP
POOL_BUF = max(POOL_WINDOWS) - 1
CONV_WIDTH = D_MODEL // 2
CONV_K = 3
CONV_BUF = CONV_K - 1
CHUNK = 128
N_SGU_GROUPS = 4
SGU_GROUP = D_MODEL // 16
SGU_WIDTH = N_SGU_GROUPS * SGU_GROUP
N_BRANCH = 3
D_FF = 4 * D_MODEL
N_MOD = 6
EPS = 1e-6
OFF_POOL = 0
OFF_CONV = OFF_POOL + POOL_WIDTH
OFF_SGU = OFF_CONV + 3 * CONV_WIDTH
OFF_GATE = OFF_SGU + 2 * SGU_WIDTH
N_IN = OFF_GATE + N_BRANCH * D_MODEL

kernel_name = "hybrid_pool_conv_sgu_decoder_step"


def rmsnorm(x, g):
    xf = x.astype(jnp.float32)
    r = xf * lax.rsqrt(jnp.mean(xf * xf, axis=-1, keepdims=True) + EPS)
    return (r * g.astype(jnp.float32)).astype(x.dtype)


def pool_mix(p, prefix, pos, w_grp, scale):
    N, T, _ = p.shape
    full = jnp.concatenate([prefix, p], axis=1).astype(jnp.float32)
    cs = jnp.pad(jnp.cumsum(full, axis=1), ((0, 0), (1, 0), (0, 0)))
    hi = cs[:, POOL_BUF + 1:POOL_BUF + 1 + T]
    pf = p.astype(jnp.float32)
    outs = []
    for g, w in enumerate(POOL_WINDOWS):
        sl = slice(g * POOL_GROUP, (g + 1) * POOL_GROUP)
        lo = cs[:, POOL_BUF + 1 - w:POOL_BUF + 1 - w + T, sl]
        cnt = jnp.minimum(pos + 1, w).astype(jnp.float32)[None, :, None]
        outs.append((hi[..., sl] - lo) / cnt - pf[..., sl])
    d = jnp.stack(outs, axis=2)
    y = jnp.einsum('ntgc,gcd->ntgd', d, w_grp).reshape(N, T, POOL_WIDTH) * scale
    return y.astype(p.dtype)


def short_conv(z, prefix, w_conv):
    T = z.shape[1]
    full = jnp.concatenate([prefix, z], axis=1)
    return sum(w_conv[k] * full[:, k:k + T] for k in range(CONV_K))


def spatial_gate(v, w_s, b_s, L):
    N, T, _ = v.shape
    vf = v.reshape(N, T // L, L, N_SGU_GROUPS, SGU_GROUP)
    w = jnp.tril(w_s[:, :L, :L])
    out = jnp.einsum('gij,nkjgc->nkigc', w, vf) + b_s[:, :L].T[None, None, :, :, None]
    return out.reshape(N, T, SGU_WIDTH)


def layer(x, c, pool_prefix, conv_prefix, pos, L, norm1, norm2, w_ada, b_ada, w_in,
          w_pool_grp, pool_scale, w_conv, sgu_norm, w_sgu, b_sgu,
          w_br_pool, w_br_conv, w_br_sgu, w_out, w_ff1, w_ff2):
    N, T, D = x.shape
    mod = (jax.nn.silu(c) @ w_ada + b_ada).reshape(N, 1, N_MOD, D)
    sh1, sc1, g1, sh2, sc2, g2 = [mod[:, :, i] for i in range(N_MOD)]
    h = rmsnorm(x, norm1) * (1 + sc1) + sh1
    proj = h @ w_in
    p = proj[..., OFF_POOL:OFF_CONV]
    xc, bc, cc = jnp.split(proj[..., OFF_CONV:OFF_SGU], 3, axis=-1)
    u, v = jnp.split(proj[..., OFF_SGU:OFF_GATE], 2, axis=-1)
    gates = jax.nn.sigmoid(proj[..., OFF_GATE:]).reshape(N, T, N_BRANCH, D)
    pool_out = pool_mix(p, pool_prefix, pos, w_pool_grp, pool_scale)
    z = cc * xc
    conv_out = bc * short_conv(z, conv_prefix, w_conv)
    v = rmsnorm(jax.nn.gelu(v), sgu_norm)
    sgu_out = jax.nn.gelu(u) * spatial_gate(v, w_sgu, b_sgu, L)
    merged = (gates[:, :, 0] * (pool_out @ w_br_pool)
              + gates[:, :, 1] * (conv_out @ w_br_conv)
              + gates[:, :, 2] * (sgu_out @ w_br_sgu))
    x = x + g1 * (merged @ w_out)
    h2 = rmsnorm(x, norm2) * (1 + sc2) + sh2
    x = x + g2 * (jnp.square(jax.nn.relu(h2 @ w_ff1)) @ w_ff2)
    new_pool = jnp.concatenate([pool_prefix, p], axis=1)[:, -POOL_BUF:]
    new_conv = jnp.concatenate([conv_prefix, z], axis=1)[:, -CONV_BUF:]
    new_v = v[:, T - L:]
    return x, new_pool, new_conv, new_v


def setup_inputs(seed: int = 0) -> dict:
    key = jax.random.key(seed)
    ks = jax.random.split(key, 24)
    f32 = jnp.float32
    nrm = lambda k, shape, s: jax.random.normal(k, shape, f32) * s
    return {
        "x_prompt": nrm(ks[0], (BATCH, SEQ, D_MODEL), 1.0),
        "x_sample": nrm(ks[1], (DEC_BATCH, DEC_SEQ, D_MODEL), 1.0),
        "state_pool": nrm(ks[2], (DEPTH, DEC_BATCH, POOL_BUF, POOL_WIDTH), 1.0),
        "state_conv": nrm(ks[3], (DEPTH, DEC_BATCH, CONV_BUF, CONV_WIDTH), 1.0),
        "c_prompt": nrm(ks[4], (BATCH, D_MODEL), 1.0),
        "c_sample": nrm(ks[5], (DEC_BATCH, D_MODEL), 1.0),
        "norm1": 1.0 + nrm(ks[6], (DEPTH, D_MODEL), 0.05),
        "norm2": 1.0 + nrm(ks[7], (DEPTH, D_MODEL), 0.05),
        "w_ada": nrm(ks[8], (DEPTH, D_MODEL, N_MOD * D_MODEL), 0.5 * D_MODEL ** -0.5),
        "b_ada": nrm(ks[9], (DEPTH, N_MOD * D_MODEL), 0.02),
        "w_in": nrm(ks[10], (DEPTH, D_MODEL, N_IN), D_MODEL ** -0.5),
        "w_pool_grp": nrm(ks[11], (DEPTH, N_POOL_GROUPS, POOL_GROUP, POOL_GROUP), POOL_GROUP ** -0.5),
        "pool_scale": 1.0 + nrm(ks[12], (DEPTH, POOL_WIDTH), 0.1),
        "w_conv": nrm(ks[13], (DEPTH, CONV_K, CONV_WIDTH), CONV_K ** -0.5),
        "sgu_norm": 1.0 + nrm(ks[14], (DEPTH, SGU_WIDTH), 0.05),
        "w_sgu": nrm(ks[15], (DEPTH, N_SGU_GROUPS, CHUNK, CHUNK), CHUNK ** -0.5),
        "b_sgu": 1.0 + nrm(ks[16], (DEPTH, N_SGU_GROUPS, CHUNK), 0.1),
        "w_br_pool": nrm(ks[17], (DEPTH, POOL_WIDTH, D_MODEL), POOL_WIDTH ** -0.5),
        "w_br_conv": nrm(ks[18], (DEPTH, CONV_WIDTH, D_MODEL), CONV_WIDTH ** -0.5),
        "w_br_sgu": nrm(ks[19], (DEPTH, SGU_WIDTH, D_MODEL), SGU_WIDTH ** -0.5),
        "w_out": nrm(ks[20], (DEPTH, D_MODEL, D_MODEL), D_MODEL ** -0.5),
        "w_ff1": nrm(ks[21], (DEPTH, D_MODEL, D_FF), D_MODEL ** -0.5),
        "w_ff2": nrm(ks[22], (DEPTH, D_FF, D_MODEL), D_FF ** -0.5),
        "final_norm": 1.0 + nrm(ks[23], (D_MODEL,), 0.05),
    }


def reference(x_prompt, x_sample, state_pool, state_conv, c_prompt, c_sample,
              norm1, norm2, w_ada, b_ada, w_in, w_pool_grp, pool_scale, w_conv,
              sgu_norm, w_sgu, b_sgu, w_br_pool, w_br_conv, w_br_sgu, w_out,
              w_ff1, w_ff2, final_norm):
    Bp, Tp, _ = x_prompt.shape
    Ts = x_sample.shape[1]
    pos_p = jnp.arange(Tp, dtype=jnp.int32)
    pos_s = PAST_LEN + jnp.arange(Ts, dtype=jnp.int32)
    zero_pool = jnp.zeros((Bp, POOL_BUF, POOL_WIDTH), x_prompt.dtype)
    zero_conv = jnp.zeros((Bp, CONV_BUF, CONV_WIDTH), x_prompt.dtype)
    xp, xs = x_prompt, x_sample
    pp, cp, vp, ps, cs_, vs = [], [], [], [], [], []
    for l in range(DEPTH):
        params = (norm1[l], norm2[l], w_ada[l], b_ada[l], w_in[l], w_pool_grp[l],
                  pool_scale[l], w_conv[l], sgu_norm[l], w_sgu[l], b_sgu[l],
                  w_br_pool[l], w_br_conv[l], w_br_sgu[l], w_out[l], w_ff1[l], w_ff2[l])
        xp, a, b, c = layer(xp, c_prompt, zero_pool, zero_conv, pos_p, CHUNK, *params)
        pp.append(a); cp.append(b); vp.append(c)
        xs, a, b, c = layer(xs, c_sample, state_pool[l], state_conv[l], pos_s, Ts, *params)
        ps.append(a); cs_.append(b); vs.append(c)
    y_prompt = rmsnorm(xp, final_norm)
    y_sample = rmsnorm(xs, final_norm)
    return (y_prompt, y_sample, jnp.stack(pp), jnp.stack(cp), jnp.stack(vp),
            jnp.stack(ps), jnp.stack(cs_), jnp.stack(vs))
```

```cpp
#include <hip/hip_runtime.h>
#include <cstdio>

#ifndef MK_SPLIT
#define MK_SPLIT 1
#endif

#define GAS __attribute__((address_space(1)))
#define LAS __attribute__((address_space(3)))
typedef unsigned short bf16;
typedef short bf16x8 __attribute__((ext_vector_type(8)));
typedef float f32x4 __attribute__((ext_vector_type(4)));
typedef float f32x2 __attribute__((ext_vector_type(2)));
typedef unsigned u32x4 __attribute__((ext_vector_type(4)));
typedef unsigned u32x2 __attribute__((ext_vector_type(2)));

constexpr int D = 2048, MP = 8192, MS = 512, M = MP + MS, NIN = 10752, DFF = 8192, DEPTH = 4;
constexpr int NMODROWS = 132, NADA_L = 6 * D  , NADA = DEPTH * NADA_L  ;
constexpr int TP = 2048;
constexpr float EPS = 1e-6f;
constexpr size_t O_YP = 0, O_YS = 16777216, O_POOLP = 17825792, O_CONVP = 17948672, O_VP = 17981440, O_POOLS = 19030016, O_CONVS = 22962176, O_VS = 24010752, O_END = 25059328;

constexpr size_t MiB = 1u << 20;
constexpr size_t WS_CTL = 0, CTL_ZERO_BYTES = 1 * MiB;
constexpr size_t WS_SC = 1 * MiB;
constexpr size_t WS_MOD = 2 * MiB;
constexpr size_t WS_X = 28 * MiB;
constexpr size_t WS_H = 96 * MiB;
constexpr size_t WS_P = 130 * MiB;
constexpr size_t WS_Z = 147 * MiB;
constexpr size_t WS_BC = 164 * MiB;
constexpr size_t WS_GU = 181 * MiB;
constexpr size_t WS_GV = 190 * MiB;
constexpr size_t WS_G = 199 * MiB;
constexpr size_t WS_BR = 301 * MiB;
constexpr size_t WS_MG = 335 * MiB;
constexpr size_t WS_ACT = 369 * MiB;
constexpr size_t WS_SSQ = 505 * MiB;
constexpr size_t WS_WADA = 506 * MiB;
constexpr size_t WS_WL = 698 * MiB;
constexpr size_t WL_STRIDE = 122 * MiB, WL_IN = 0, WL_BR = 42 * MiB, WL_OUT = 50 * MiB, WL_FF1 = 58 * MiB, WL_FF2 = 90 * MiB;
constexpr size_t WS_END = WS_WL + 4 * WL_STRIDE;
constexpr int CW_TMO = 0;
constexpr int CW_BAR = 4096;

constexpr int RING_BYTES = 131072;
constexpr int MISC_OFF = RING_BYTES + 320;
constexpr int LDS_BYTES = 147456;
constexpr int NWAVES = 8;

#define RLX_AGENT __ATOMIC_RELAXED, __HIP_MEMORY_SCOPE_AGENT
#define LDS_WAIT() asm volatile("s_waitcnt lgkmcnt(0)" ::: "memory")
#define VM_WAIT() asm volatile("s_waitcnt vmcnt(0)" ::: "memory")

__device__ __forceinline__ unsigned cvt_pk_bf16(float lo, float hi) { unsigned r; asm volatile("v_cvt_pk_bf16_f32 %0, %1, %2" : "=v"(r) : "v"(lo), "v"(hi)); return r; }
__device__ __forceinline__ float bf_lo(unsigned w) { return __builtin_bit_cast(float, w << 16); }
__device__ __forceinline__ float bf_hi(unsigned w) { return __builtin_bit_cast(float, w & 0xffff0000u); }
__device__ __forceinline__ float fsigmoid(float x) { return __builtin_amdgcn_rcpf(1.0f + __builtin_amdgcn_exp2f(-1.4426950408889634f * x)); }
__device__ __forceinline__ float fgelu(float x) {
    const float u = x * (1.0f + 0.044715f * x * x);
    return x * __builtin_amdgcn_rcpf(1.0f + __builtin_amdgcn_exp2f(-2.3022081535f * u));
}
__device__ __forceinline__ float wave_sum(float v) {
#pragma unroll
    for (int o = 1; o < 64; o <<= 1) v += __shfl_xor(v, o);
    return v;
}
__device__ __forceinline__ int mod_row(int r) { return r < MP ? (r >> 11) : 4 + ((r - MP) >> 2); }

namespace pg8 {
constexpr int BM = 256, BK = 64, HALF = 128, HTB = HALF * BK * 2, STAGE_BYTES = 8 * HTB, NXCD = 8, WGM = 8;
__host__ __device__ __forceinline__ int lds_byte(int r, int c) { const int st = (r >> 4) * 2 + (c >> 5), rr = r & 15, cc = c & 31, ob = rr * 64 + cc * 2; return st * 1024 + (ob ^ (((ob >> 9) & 1) << 5)); }
__host__ __device__ __forceinline__ void stage_rc(int b, int& R, int& C) { const int st = b / 1024, sb = b % 1024, swz = sb ^ (((sb >> 9) & 1) << 5); R = (st >> 1) * 16 + swz / 64; C = (st & 1) * 32 + (swz % 64) / 2; }
__host__ __device__ __forceinline__ int perm32(int rho) { const int n = rho >> 4, i = rho & 15; return 8 * (i >> 2) + 4 * n + (i & 3); }

struct Seg { int pm, pn, k0, nt, sg, keep; };
struct Gemm { const bf16* A; const bf16* Bt; int KS; };

struct TileOrder {
    int nM, nN, nwg, G, c, nseg, kt;
    __device__ void init(int M_, int N_, int G_, int c_, int K_) { nM = M_ / BM; nN = N_ / BM; nwg = nM * nN; G = G_; c = c_; nseg = 1; kt = K_ / BK; }
    __device__ bool next(int i, Seg& u) const {
        const int iu = i / nseg, sg = i - iu * nseg;
        const long L = (long)iu * G + c; if (L >= nwg) return false;
        int wgid = (int)L; { const int q = nwg / NXCD, r = nwg % NXCD, xcd = wgid % NXCD, off = wgid / NXCD; wgid = (xcd < r ? xcd * (q + 1) : r * (q + 1) + (xcd - r) * q) + off; }
        const int nig = WGM * nN, gid = wgid / nig, fm = gid * WGM, gsz = (nM - fm) < WGM ? (nM - fm) : WGM;
        u.pm = fm + ((wgid % nig) % gsz); u.pn = (wgid % nig) / gsz; u.sg = sg;
        if (nseg == 1) { u.k0 = 0; u.nt = kt; u.keep = 0; }
        else { u.k0 = sg == 0 ? 0 : (sg == 1 ? 8 : 24); u.nt = sg == 1 ? 16 : 8; u.keep = sg < 2 ? 1 : 0; }
        return true;
    }
};

template <class Epi, class Sched, bool ALIGN_EPI, bool SP2>
__device__ __forceinline__ void gemm_phase(LAS unsigned char* lds, const Gemm g, const Sched& S, const Epi& E) {
    int tid = threadIdx.x; asm volatile("" : "+v"(tid));
    const int wid = __builtin_amdgcn_readfirstlane(tid >> 6), lane = tid & 63, wr = wid >> 2, wc = wid & 3, fr = lane & 15, fq = lane >> 4;
    const int K = g.KS;
    unsigned voffA[2], voffB[2];
#pragma unroll
    for (int i = 0; i < 2; ++i) { int R, C; stage_rc(tid * 16 + i * 8192, R, C); const int Rb = (R & ~31) + perm32(R & 31);
        voffA[i] = (unsigned)(R * K + C) * 2u; voffB[i] = (unsigned)(Rb * K + C) * 2u; }
    const size_t kstep = (size_t)(BK * 2);
    const size_t hstep = (size_t)HALF * K * 2;
    const size_t tstep = 2 * hstep;
    const unsigned ldsw = (unsigned)wid * 1024u;
    const int aoff = lds_byte(wr * 64 + fr, fq * 8), boff = lds_byte(wc * 32 + fr, fq * 8);
#define PG8_SA(b, h) (((b) * 2 + (h)) * HTB)
#define PG8_SB(b, h) ((4 + (b) * 2 + (h)) * HTB)
#define PG8_STAGE(bufoff, gbase, voff) do { _Pragma("unroll") for (int _i = 0; _i < 2; ++_i) \
        __builtin_amdgcn_global_load_lds((const unsigned*)((const char*)(gbase) + (voff)[_i]), (LAS unsigned*)(lds + (bufoff) + ldsw + _i * 8192), 16, 0, 0); } while (0)
#define PG8_LDA(dst, b, h) do { _Pragma("unroll") for (int m = 0; m < 4; ++m) _Pragma("unroll") for (int k = 0; k < 2; ++k) dst[m][k] = *(const LAS bf16x8*)(lds + PG8_SA(b, h) + aoff + m * 2048 + k * 1024); } while (0)
#define PG8_LDB(dst, b, h) do { _Pragma("unroll") for (int n = 0; n < 2; ++n) _Pragma("unroll") for (int k = 0; k < 2; ++k) dst[n][k] = *(const LAS bf16x8*)(lds + PG8_SB(b, h) + boff + n * 2048 + k * 1024); } while (0)
#define PG8_MMA(ai, bj, At, Bt) do { __builtin_amdgcn_s_setprio(1); _Pragma("unroll") for (int m = 0; m < 4; ++m) _Pragma("unroll") for (int n = 0; n < 2; ++n) _Pragma("unroll") for (int k = 0; k < 2; ++k) \
        acc[ai][bj][m][n] = __builtin_amdgcn_mfma_f32_16x16x32_bf16(Bt[n][k], At[m][k], acc[ai][bj][m][n], 0, 0, 0); __builtin_amdgcn_s_setprio(0); } while (0)
#define PG8_WAIT_V(n) asm volatile("s_waitcnt vmcnt(" #n ")" ::: "memory")
#define PG8_WAIT_L(n) asm volatile("s_waitcnt lgkmcnt(" #n ")" ::: "memory")
#define PG8_BAR __builtin_amdgcn_s_barrier()
#define PG8_SCHED __builtin_amdgcn_sched_barrier(0)
    Seg cur, nxt; int ui = 0;
    if (!S.next(0, cur)) return;
    f32x4 acc[2][2][4][2];
#pragma unroll
    for (int a = 0; a < 2; ++a)
#pragma unroll
        for (int b = 0; b < 2; ++b)
#pragma unroll
            for (int m = 0; m < 4; ++m)
#pragma unroll
                for (int n = 0; n < 2; ++n) acc[a][b][m][n] = (f32x4){0.f, 0.f, 0.f, 0.f};
    bf16x8 At[4][2], B0[2][2], B1[2][2];
    const char* cA = (const char*)g.A + (size_t)cur.pm * tstep + (size_t)cur.k0 * kstep; const char* cB = (const char*)g.Bt + (size_t)cur.pn * tstep + (size_t)cur.k0 * kstep;
    if constexpr (SP2) {
        PG8_STAGE(PG8_SB(0, 0), cB, voffB); PG8_STAGE(PG8_SB(0, 1), cB + hstep, voffB); PG8_STAGE(PG8_SA(0, 0), cA, voffA); PG8_STAGE(PG8_SA(0, 1), cA + hstep, voffA);
        if (wr == 1) PG8_BAR;
        PG8_WAIT_V(2); PG8_BAR;
        PG8_STAGE(PG8_SB(1, 0), cB + kstep, voffB); PG8_STAGE(PG8_SA(1, 0), cA + kstep, voffA); PG8_STAGE(PG8_SB(1, 1), cB + hstep + kstep, voffB);
        PG8_WAIT_V(6); PG8_BAR;
    } else {
        PG8_STAGE(PG8_SB(0, 0), cB, voffB); PG8_STAGE(PG8_SA(0, 0), cA, voffA); PG8_STAGE(PG8_SB(0, 1), cB + hstep, voffB); PG8_STAGE(PG8_SA(0, 1), cA + hstep, voffA);
        if (wr == 1) PG8_BAR;
        PG8_WAIT_V(4); PG8_BAR;
        PG8_STAGE(PG8_SB(1, 0), cB + kstep, voffB); PG8_STAGE(PG8_SA(1, 0), cA + kstep, voffA); PG8_STAGE(PG8_SB(1, 1), cB + hstep + kstep, voffB);
        PG8_WAIT_V(6); PG8_BAR;
    }
    for (;;) {
        const bool has_next = S.next(ui + 1, nxt);
        const char* nA = has_next ? (const char*)g.A + (size_t)nxt.pm * tstep + (size_t)nxt.k0 * kstep : cA; const char* nB = has_next ? (const char*)g.Bt + (size_t)nxt.pn * tstep + (size_t)nxt.k0 * kstep : cB;
        const int nt = cur.nt;
        for (int t = 0; t < nt; t += 2) {
            const bool last = (t == nt - 2);
            const char* a1 = cA + (size_t)(t + 1) * kstep;
            const char* a2 = last ? nA : cA + (size_t)(t + 2) * kstep; const char* b2 = last ? nB : cB + (size_t)(t + 2) * kstep;
            const char* a3 = a2 + kstep; const char* b3 = b2 + kstep;
            if constexpr (SP2) {
            PG8_LDB(B0, 0, 0); PG8_LDB(B1, 0, 1); PG8_SCHED; PG8_LDA(At, 0, 0); PG8_STAGE(PG8_SA(1, 1), a1 + hstep, voffA);
            PG8_WAIT_V(8); PG8_WAIT_L(0); PG8_BAR; PG8_MMA(0, 0, At, B0); PG8_MMA(0, 1, At, B1); PG8_BAR; PG8_SCHED;
            PG8_LDA(At, 0, 1); PG8_STAGE(PG8_SB(0, 0), b2, voffB); PG8_STAGE(PG8_SB(0, 1), b2 + hstep, voffB); PG8_STAGE(PG8_SA(0, 0), a2, voffA);
            PG8_WAIT_V(8); PG8_WAIT_L(0); PG8_BAR; PG8_MMA(1, 0, At, B0); PG8_MMA(1, 1, At, B1); PG8_BAR; PG8_SCHED;
            PG8_LDB(B0, 1, 0); PG8_LDB(B1, 1, 1); PG8_SCHED; PG8_LDA(At, 1, 0); PG8_STAGE(PG8_SA(0, 1), a2 + hstep, voffA);
            PG8_WAIT_V(8); PG8_WAIT_L(0); PG8_BAR; PG8_MMA(0, 0, At, B0); PG8_MMA(0, 1, At, B1); PG8_BAR; PG8_SCHED;
            PG8_LDA(At, 1, 1); PG8_STAGE(PG8_SB(1, 0), b3, voffB); PG8_STAGE(PG8_SB(1, 1), b3 + hstep, voffB); PG8_STAGE(PG8_SA(1, 0), a3, voffA);
            PG8_WAIT_V(8); PG8_WAIT_L(0); PG8_BAR; PG8_MMA(1, 0, At, B0); PG8_MMA(1, 1, At, B1); PG8_BAR; PG8_SCHED;
            } else {
            PG8_LDB(B0, 0, 0); PG8_SCHED; PG8_LDA(At, 0, 0); PG8_STAGE(PG8_SA(1, 1), a1 + hstep, voffA);
            PG8_WAIT_L(8); PG8_BAR; PG8_WAIT_L(0); PG8_MMA(0, 0, At, B0); PG8_BAR; PG8_SCHED;
            PG8_LDB(B1, 0, 1); PG8_STAGE(PG8_SB(0, 0), b2, voffB);
            PG8_BAR; PG8_WAIT_L(0); PG8_MMA(0, 1, At, B1); PG8_BAR;
            PG8_LDA(At, 0, 1); PG8_STAGE(PG8_SA(0, 0), a2, voffA);
            PG8_BAR; PG8_WAIT_L(0); PG8_MMA(1, 0, At, B0); PG8_BAR; PG8_SCHED;
            PG8_STAGE(PG8_SB(0, 1), b2 + hstep, voffB);
            PG8_WAIT_V(6); PG8_BAR; PG8_MMA(1, 1, At, B1); PG8_BAR;
            PG8_LDB(B0, 1, 0); PG8_SCHED; PG8_LDA(At, 1, 0); PG8_STAGE(PG8_SA(0, 1), a2 + hstep, voffA);
            PG8_WAIT_L(8); PG8_BAR; PG8_WAIT_L(0); PG8_MMA(0, 0, At, B0); PG8_BAR; PG8_SCHED;
            PG8_LDB(B1, 1, 1); PG8_STAGE(PG8_SB(1, 0), b3, voffB);
            PG8_BAR; PG8_WAIT_L(0); PG8_MMA(0, 1, At, B1); PG8_BAR;
            PG8_LDA(At, 1, 1); PG8_STAGE(PG8_SA(1, 0), a3, voffA);
            PG8_BAR; PG8_WAIT_L(0); PG8_MMA(1, 0, At, B0); PG8_BAR; PG8_SCHED;
            PG8_STAGE(PG8_SB(1, 1), b3 + hstep, voffB);
            PG8_WAIT_V(6); PG8_BAR; PG8_MMA(1, 1, At, B1); PG8_BAR;
            }
        }
        if constexpr (ALIGN_EPI) { if (wr == 0) PG8_BAR; }
        E(acc, cur, wr, wc, fr, fq);
        if (!has_next) break;
        if (!cur.keep) {
#pragma unroll
        for (int a = 0; a < 2; ++a)
#pragma unroll
            for (int b = 0; b < 2; ++b)
#pragma unroll
                for (int m = 0; m < 4; ++m)
#pragma unroll
                    for (int n = 0; n < 2; ++n) acc[a][b][m][n] = (f32x4){0.f, 0.f, 0.f, 0.f};
        }
        cur = nxt; cA = nA; cB = nB; ++ui;
        if constexpr (ALIGN_EPI) { if (wr == 1) PG8_BAR; }
    }
    PG8_WAIT_V(0);
    if constexpr (!ALIGN_EPI) { if (wr == 0) PG8_BAR; }
    PG8_BAR;
#undef PG8_SA
#undef PG8_SB
#undef PG8_STAGE
#undef PG8_LDA
#undef PG8_LDB
#undef PG8_MMA
#undef PG8_WAIT_V
#undef PG8_WAIT_L
#undef PG8_BAR
#undef PG8_SCHED
}
}
using pg8::Seg;
typedef f32x4 Acc[2][2][4][2];

struct EpiAda {
    float* MOD; const float* bias;
    __device__ __forceinline__ void operator()(Acc& acc, const Seg& u, int wr, int wc, int fr, int fq) const {
#pragma unroll
        for (int ai = 0; ai < 2; ++ai)
#pragma unroll
            for (int m = 0; m < 4; ++m) { const int r = ai * 128 + wr * 64 + m * 16 + fr;
                if (r < NMODROWS) {
#pragma unroll
                for (int bj = 0; bj < 2; ++bj) { const int col = u.pn * 256 + bj * 128 + wc * 32 + 8 * fq;
                    const f32x4 b0 = *(const f32x4*)(bias + col), b1 = *(const f32x4*)(bias + col + 4);
                    float* o = MOD + (size_t)r * NADA + col; *(f32x4*)o = acc[ai][bj][m][0] + b0; *(f32x4*)(o + 4) = acc[ai][bj][m][1] + b1; } } }
    }
};
struct EpiIn {
    float* P; bf16* Z; bf16* BC; bf16* GU; bf16* GV; bf16* G; float* SSQ; float* out; int layer;
    __device__ __forceinline__ void operator()(Acc& acc, const Seg& u, int wr, int wc, int fr, int fq) const {
        const int pn = u.pn, pm = u.pm;
        const bool samp = pm >= 32;
#pragma unroll
        for (int ai = 0; ai < 2; ++ai)
#pragma unroll
            for (int m = 0; m < 4; ++m) {
                const int lr = ai * 128 + wr * 64 + m * 16 + fr; const int r = pm * 256 + lr;
                const int t = samp ? (lr & 3) : ((pm & 7) * 256 + lr);
                const int bn = samp ? ((pm - 32) * 64 + (lr >> 2)) : (pm >> 3);
                if (pn < 2) {
                    const bool st = samp ? true : (t >= TP - 15);
                    const size_t so = samp ? O_POOLS + ((size_t)(layer * 128 + bn) * 15 + 11 + t) * 512 : O_POOLP + ((size_t)(layer * 4 + bn) * 15 + (t - (TP - 15))) * 512;
#pragma unroll
                    for (int bj = 0; bj < 2; ++bj) { const int col = pn * 256 + bj * 128 + wc * 32 + 8 * fq;
                        float* o = P + (size_t)r * 512 + col; *(f32x4*)o = acc[ai][bj][m][0]; *(f32x4*)(o + 4) = acc[ai][bj][m][1];
                        if (st) { float* s = out + so + col; *(f32x4*)s = acc[ai][bj][m][0]; *(f32x4*)(s + 4) = acc[ai][bj][m][1]; } }
                } else if (pn < 10) {
                    const int ch = (pn - 2) * 128 + wc * 32 + 8 * fq;
                    const f32x4 z0 = acc[ai][0][m][0] * acc[ai][1][m][0], z1 = acc[ai][0][m][1] * acc[ai][1][m][1];
                    u32x4 w; w.x = cvt_pk_bf16(z0[0], z0[1]); w.y = cvt_pk_bf16(z0[2], z0[3]); w.z = cvt_pk_bf16(z1[0], z1[1]); w.w = cvt_pk_bf16(z1[2], z1[3]);
                    *(u32x4*)(Z + (size_t)r * 1024 + ch) = w;
                    const bool st = samp ? (t >= 2) : (t >= TP - 2);
                    if (st) { const size_t so = samp ? O_CONVS + ((size_t)(layer * 128 + bn) * 2 + (t - 2)) * 1024 : O_CONVP + ((size_t)(layer * 4 + bn) * 2 + (t - (TP - 2))) * 1024;
                        float* s = out + so + ch; *(f32x4*)s = z0; *(f32x4*)(s + 4) = z1; }
                } else if (pn < 14) {
#pragma unroll
                    for (int bj = 0; bj < 2; ++bj) { const int col = (pn - 10) * 256 + bj * 128 + wc * 32 + 8 * fq; const f32x4 v0 = acc[ai][bj][m][0], v1 = acc[ai][bj][m][1];
                        u32x4 w; w.x = cvt_pk_bf16(v0[0], v0[1]); w.y = cvt_pk_bf16(v0[2], v0[3]); w.z = cvt_pk_bf16(v1[0], v1[1]); w.w = cvt_pk_bf16(v1[2], v1[3]);
                        *(u32x4*)(BC + (size_t)r * 1024 + col) = w; }
                } else if (pn < 18) {
                    const bool isv = pn >= 16; bf16* O = isv ? GV : GU; float ss = 0.f;
#pragma unroll
                    for (int bj = 0; bj < 2; ++bj) { const int col = ((pn - 14) & 1) * 256 + bj * 128 + wc * 32 + 8 * fq; f32x4 v0 = acc[ai][bj][m][0], v1 = acc[ai][bj][m][1];
#pragma unroll
                        for (int j = 0; j < 4; ++j) { v0[j] = fgelu(v0[j]); v1[j] = fgelu(v1[j]); ss += v0[j] * v0[j] + v1[j] * v1[j]; }
                        u32x4 w; w.x = cvt_pk_bf16(v0[0], v0[1]); w.y = cvt_pk_bf16(v0[2], v0[3]); w.z = cvt_pk_bf16(v1[0], v1[1]); w.w = cvt_pk_bf16(v1[2], v1[3]);
                        *(u32x4*)(O + (size_t)r * 512 + col) = w; }
                    if (isv) { ss += __shfl_xor(ss, 16); ss += __shfl_xor(ss, 32); if (fq == 0) unsafeAtomicAdd(SSQ + r, ss); }
                } else {
#pragma unroll
                    for (int bj = 0; bj < 2; ++bj) { const int col = (pn - 18) * 256 + bj * 128 + wc * 32 + 8 * fq; f32x4 v0 = acc[ai][bj][m][0], v1 = acc[ai][bj][m][1];
#pragma unroll
                        for (int j = 0; j < 4; ++j) { v0[j] = fmaxf(fsigmoid(v0[j]), 1e-9f); v1[j] = fmaxf(fsigmoid(v1[j]), 1e-9f); }
                        u32x4 w; w.x = cvt_pk_bf16(v0[0], v0[1]); w.y = cvt_pk_bf16(v0[2], v0[3]); w.z = cvt_pk_bf16(v1[0], v1[1]); w.w = cvt_pk_bf16(v1[2], v1[3]);
                        *(u32x4*)(G + (size_t)r * 6144 + col) = w; }
                }
                asm volatile("" ::: "memory");
            }
    }
};
struct EpiMerge {
    const bf16* G; bf16* MG;
    __device__ __forceinline__ void operator()(Acc& acc, const Seg& u, int wr, int wc, int fr, int fq) const {
        const int sg = u.sg;
#pragma unroll
        for (int ai = 0; ai < 2; ++ai)
#pragma unroll
            for (int m = 0; m < 4; ++m) { const int r = u.pm * 256 + ai * 128 + wr * 64 + m * 16 + fr;
#pragma unroll
                for (int bj = 0; bj < 2; ++bj) { const int col = u.pn * 256 + bj * 128 + wc * 32 + 8 * fq;
                    const bf16* gp = G + (size_t)r * 6144 + col;
                    if (sg < 2) {
                        const u32x4 a = *(const u32x4*)(gp + sg * 2048), b = *(const u32x4*)(gp + (sg + 1) * 2048);
                        f32x4 r0, r1;
                        r0[0] = bf_lo(a.x) * __builtin_amdgcn_rcpf(bf_lo(b.x)); r0[1] = bf_hi(a.x) * __builtin_amdgcn_rcpf(bf_hi(b.x)); r0[2] = bf_lo(a.y) * __builtin_amdgcn_rcpf(bf_lo(b.y)); r0[3] = bf_hi(a.y) * __builtin_amdgcn_rcpf(bf_hi(b.y));
                        r1[0] = bf_lo(a.z) * __builtin_amdgcn_rcpf(bf_lo(b.z)); r1[1] = bf_hi(a.z) * __builtin_amdgcn_rcpf(bf_hi(b.z)); r1[2] = bf_lo(a.w) * __builtin_amdgcn_rcpf(bf_lo(b.w)); r1[3] = bf_hi(a.w) * __builtin_amdgcn_rcpf(bf_hi(b.w));
                        acc[ai][bj][m][0] *= r0; acc[ai][bj][m][1] *= r1;
                    } else {
                        const u32x4 a = *(const u32x4*)(gp + 2 * 2048);
                        const f32x4 g0 = {bf_lo(a.x), bf_hi(a.x), bf_lo(a.y), bf_hi(a.y)}, g1 = {bf_lo(a.z), bf_hi(a.z), bf_lo(a.w), bf_hi(a.w)};
                        const f32x4 v0 = acc[ai][bj][m][0] * g0, v1 = acc[ai][bj][m][1] * g1;
                        u32x4 w; w.x = cvt_pk_bf16(v0[0], v0[1]); w.y = cvt_pk_bf16(v0[2], v0[3]); w.z = cvt_pk_bf16(v1[0], v1[1]); w.w = cvt_pk_bf16(v1[2], v1[3]);
                        *(u32x4*)(MG + (size_t)r * D + col) = w;
                    } }
                asm volatile("" ::: "memory"); }
    }
};
struct EpiRes {
    float* X; const float* gate;
    __device__ __forceinline__ void operator()(Acc& acc, const Seg& u, int wr, int wc, int fr, int fq) const {
#pragma unroll
        for (int ai = 0; ai < 2; ++ai)
#pragma unroll
            for (int m = 0; m < 4; ++m) { const int r = u.pm * 256 + ai * 128 + wr * 64 + m * 16 + fr; const float* gr = gate + (size_t)mod_row(r) * NADA;
#pragma unroll
                for (int bj = 0; bj < 2; ++bj) { const int col = u.pn * 256 + bj * 128 + wc * 32 + 8 * fq;
                    float* xp = X + (size_t)r * D + col;
                    const f32x4 g0 = *(const f32x4*)(gr + col), g1 = *(const f32x4*)(gr + col + 4), x0 = *(const f32x4*)xp, x1 = *(const f32x4*)(xp + 4);
                    *(f32x4*)xp = x0 + g0 * acc[ai][bj][m][0]; *(f32x4*)(xp + 4) = x1 + g1 * acc[ai][bj][m][1]; }
                asm volatile("" ::: "memory"); }
    }
};
struct EpiRelu2 {
    bf16* O;
    __device__ __forceinline__ void operator()(Acc& acc, const Seg& u, int wr, int wc, int fr, int fq) const {
#pragma unroll
        for (int ai = 0; ai < 2; ++ai)
#pragma unroll
            for (int m = 0; m < 4; ++m) { const int r = u.pm * 256 + ai * 128 + wr * 64 + m * 16 + fr;
#pragma unroll
                for (int bj = 0; bj < 2; ++bj) { const int col = u.pn * 256 + bj * 128 + wc * 32 + 8 * fq; f32x4 v0 = acc[ai][bj][m][0], v1 = acc[ai][bj][m][1];
#pragma unroll
                    for (int j = 0; j < 4; ++j) { const float a = fmaxf(v0[j], 0.f), b = fmaxf(v1[j], 0.f); v0[j] = a * a; v1[j] = b * b; }
                    u32x4 w; w.x = cvt_pk_bf16(v0[0], v0[1]); w.y = cvt_pk_bf16(v0[2], v0[3]); w.z = cvt_pk_bf16(v1[0], v1[1]); w.w = cvt_pk_bf16(v1[2], v1[3]);
                    *(u32x4*)(O + (size_t)r * DFF + col) = w; } }
    }
};

#define XB_TMO      128
#define XB_XCNT(j)  (256  + 64 * (j))
#define XB_XSUB(j)  (1280 + 64 * (j))
#define XB_XGEN(j)  (2304 + 64 * (j))
#define XB_TOP      3328
#define XB_TOPGEN   3392
#define XCD_BAR_WORDS 3456
#define XB_SPIN_CAP (1u << 18)
__device__ __forceinline__ unsigned xb_ld(unsigned* p)              { return __hip_atomic_load(p, __ATOMIC_RELAXED, __HIP_MEMORY_SCOPE_AGENT); }
__device__ __forceinline__ unsigned xb_add(unsigned* p, unsigned v) { return __hip_atomic_fetch_add(p, v, __ATOMIC_RELAXED, __HIP_MEMORY_SCOPE_AGENT); }
__device__ __forceinline__ unsigned xb_xcc_id() { return (unsigned)__builtin_amdgcn_s_getreg((3 << 11) | 20) & 0xFu; }
#define XB_SPIN(cond, bar) do { unsigned _sp = 0; while (cond) { __builtin_amdgcn_s_sleep(1); \
    if ((++_sp & 255u) == 0u) { if (xb_ld(&(bar)[XB_TMO])) break; if (_sp > XB_SPIN_CAP) { atomicAdd(&(bar)[XB_TMO], 1u); break; } } } } while (0)
struct XcdBarrier { unsigned* bar; unsigned x; volatile LAS unsigned* st; };
__device__ __forceinline__ XcdBarrier xcd_barrier_post(unsigned* bar, volatile LAS unsigned* st) {
    XcdBarrier b; b.bar = bar; b.x = xb_xcc_id(); b.st = st;
    if (threadIdx.x == 0) (void)xb_add(&bar[XB_XCNT(b.x)], 1u);
    return b;
}
__device__ __forceinline__ void xcd_barrier_complete(unsigned* bar, unsigned x, unsigned& nloc, unsigned& nx) {
    const unsigned G = gridDim.x * gridDim.y * gridDim.z;
    unsigned sum, cnt, mine, sp = 0u;
    for (;;) {
        sum = 0u; cnt = 0u; mine = 0u;
#pragma unroll
        for (unsigned j = 0; j < 16; ++j) { const unsigned c = xb_ld(&bar[XB_XCNT(j)]); sum += c; cnt += (c > 0u) ? 1u : 0u; mine = (j == x) ? c : mine; }
        if (sum == G) break;
        __builtin_amdgcn_s_sleep(1);
        if ((++sp & 255u) == 0u) { if (xb_ld(&bar[XB_TMO])) break; if (sp > XB_SPIN_CAP) { atomicAdd(&bar[XB_TMO], 1u); break; } }
    }
    nloc = mine > 0u ? mine : 1u; nx = cnt > 0u ? cnt : 1u;
}
__device__ __forceinline__ void xcd_barrier(const XcdBarrier& b) {
    asm volatile("s_waitcnt vmcnt(0)" ::: "memory");
    __syncthreads();
    if (threadIdx.x == 0) {
        unsigned* bar = b.bar;
        __builtin_amdgcn_s_waitcnt(0);
        unsigned nloc = b.st[0], nx = b.st[1];
        if (nloc == 0u) { xcd_barrier_complete(bar, b.x, nloc, nx); b.st[0] = nloc; b.st[1] = nx; }
        const unsigned old = xb_add(&bar[XB_XSUB(b.x)], 1u);
        const unsigned gen = old / nloc;
        if (old + 1u == (gen + 1u) * nloc) {
            __builtin_amdgcn_fence(__ATOMIC_RELEASE, "agent");
            asm volatile("s_waitcnt vmcnt(0)" ::: "memory");
            const unsigned og = xb_add(&bar[XB_TOP], 1u);
            const unsigned tg = og / nx;
            if (og + 1u == (tg + 1u) * nx) xb_add(&bar[XB_TOPGEN], 1u);
            else XB_SPIN(xb_ld(&bar[XB_TOPGEN]) == tg, bar);
            __builtin_amdgcn_fence(__ATOMIC_ACQUIRE, "agent");
            xb_add(&bar[XB_XGEN(b.x)], 1u);
            asm volatile("s_waitcnt vmcnt(0)" ::: "memory");
        } else {
            XB_SPIN(xb_ld(&bar[XB_XGEN(b.x)]) == gen, bar);
            __builtin_amdgcn_fence(__ATOMIC_ACQUIRE, "agent");
            asm volatile("s_waitcnt vmcnt(0)" ::: "memory");
        }
    }
    __syncthreads();
}

struct Args { const float* in[24]; float* out; unsigned char* ws; int ph_lo, ph_hi; };
enum { I_XP = 0, I_XS, I_SPOOL, I_SCONV, I_CP, I_CS, I_NORM1, I_NORM2, I_WADA, I_BADA, I_WIN, I_WPG, I_PSCALE, I_WCONV, I_SGUN, I_WSGU, I_BSGU, I_WBRP, I_WBRC, I_WBRS, I_WOUT, I_WFF1, I_WFF2, I_FNORM };

__device__ __forceinline__ int win_row(int n) {
    if (n < 512 || n >= 3584) return n;
    if (n < 1536) { const int ch = n - 512; return 512 + 256 * (ch >> 7) + (ch & 127); }
    if (n < 2560) return 2560 + (n - 1536);
    const int ch = n - 2560; return 512 + 256 * (ch >> 7) + 128 + (ch & 127);
}
struct TrItem { const float* W; int N; bf16* dst; int DS; int koff; int kb, nb; int drow0; };
__device__ __forceinline__ void tr_load(const TrItem& it, int lane, f32x4 (&a)[8], f32x4 (&b)[8]) {
    const int nq = lane & 15, kh = lane >> 4;
    const float* src = it.W + (size_t)(it.kb * 64) * it.N + it.nb * 64 + nq * 4;
#pragma unroll
    for (int i = 0; i < 8; ++i) { const int kp = 4 * i + kh; a[i] = *(const f32x4*)(src + (size_t)(2 * kp) * it.N); b[i] = *(const f32x4*)(src + (size_t)(2 * kp + 1) * it.N); }
}
__device__ __forceinline__ void tr_store(const TrItem& it, int lane, const f32x4 (&a)[8], const f32x4 (&b)[8], LAS unsigned* T) {
    const int nq = lane & 15, kh = lane >> 4;
#pragma unroll
    for (int i = 0; i < 8; ++i) { const int kp = 4 * i + kh;
#pragma unroll
        for (int e = 0; e < 4; ++e) T[(nq * 4 + e) * 32 + (kp ^ (4 * (nq & 7)))] = cvt_pk_bf16(a[i][e], b[i][e]); }
    LDS_WAIT(); asm volatile("" ::: "memory");
    const int c = lane & 7;
#pragma unroll
    for (int j = 0; j < 8; ++j) { const int n = (lane >> 3) + 8 * j; const u32x4 v = *(const LAS u32x4*)(T + n * 32 + ((4 * c) ^ (4 * ((n >> 2) & 7))));
        *(u32x4*)(it.dst + (size_t)(it.drow0 + n) * it.DS + it.koff + it.kb * 64 + c * 8) = v; }
    LDS_WAIT(); asm volatile("" ::: "memory");
}
constexpr int IT_IN = 32 * 168, IT_BRC = 16 * 32, IT_BRS = 8 * 32, IT_OUT = 32 * 32, IT_FF1 = 32 * 128, IT_FF2 = 128 * 32, IT_ADA = 32 * 192;
constexpr int IT_LAYER = IT_IN + IT_BRC + IT_BRS + IT_OUT + IT_FF1 + IT_FF2 + IT_ADA, IT_TOTAL = DEPTH * IT_LAYER;
__device__ __forceinline__ void tr_decode(const Args& A, int id, TrItem& it) {
    const int l = id / IT_LAYER; int r = id - l * IT_LAYER;
    unsigned char* wl = A.ws + WS_WL + (size_t)l * WL_STRIDE;
    int nbk;
    if (r < IT_IN) { it.W = A.in[I_WIN] + (size_t)l * D * NIN; it.N = NIN; it.dst = (bf16*)(wl + WL_IN); it.DS = D; it.koff = 0; nbk = 168; }
    else if ((r -= IT_IN) < IT_BRC) { it.W = A.in[I_WBRC] + (size_t)l * 1024 * D; it.N = D; it.dst = (bf16*)(wl + WL_BR); it.DS = D; it.koff = 512; nbk = 32; }
    else if ((r -= IT_BRC) < IT_BRS) { it.W = A.in[I_WBRS] + (size_t)l * 512 * D; it.N = D; it.dst = (bf16*)(wl + WL_BR); it.DS = D; it.koff = 1536; nbk = 32; }
    else if ((r -= IT_BRS) < IT_OUT) { it.W = A.in[I_WOUT] + (size_t)l * D * D; it.N = D; it.dst = (bf16*)(wl + WL_OUT); it.DS = D; it.koff = 0; nbk = 32; }
    else if ((r -= IT_OUT) < IT_FF1) { it.W = A.in[I_WFF1] + (size_t)l * D * DFF; it.N = DFF; it.dst = (bf16*)(wl + WL_FF1); it.DS = D; it.koff = 0; nbk = 128; }
    else if ((r -= IT_FF1) < IT_FF2) { it.W = A.in[I_WFF2] + (size_t)l * DFF * D; it.N = D; it.dst = (bf16*)(wl + WL_FF2); it.DS = DFF; it.koff = 0; nbk = 32; }
    else { r -= IT_FF2; it.W = A.in[I_WADA] + (size_t)l * D * NADA_L; it.N = NADA_L; it.dst = (bf16*)(A.ws + WS_WADA) + (size_t)l * NADA_L * D; it.DS = D; it.koff = 0; nbk = 192; }
    it.kb = r / nbk; it.nb = r - it.kb * nbk;
    it.drow0 = (it.N == NIN) ? win_row(it.nb * 64) : it.nb * 64;
}

struct Ctx { int tid, lane, wave, G, bx, gw, NGW; unsigned char* ws; float* out; };
__device__ __forceinline__ Ctx make_ctx(const Args& a) {
    Ctx c; int t = threadIdx.x; asm volatile("" : "+v"(t)); c.tid = t; c.lane = t & 63; c.wave = __builtin_amdgcn_readfirstlane(t >> 6);
    c.G = gridDim.x; c.bx = blockIdx.x; const int vcu = (c.G % 8 == 0) ? (c.bx % 8) * (c.G / 8) + c.bx / 8 : c.bx;
    c.gw = vcu * NWAVES + c.wave; c.NGW = c.G * NWAVES;
    size_t z = 0; asm volatile("" : "+s"(z));
    c.ws = a.ws + z; c.out = a.out + z;
    return c;
}
extern __shared__ __attribute__((aligned(16))) unsigned char lds_raw[];
#define LDS_BASE ((LAS unsigned char*)lds_raw)

__device__ __forceinline__ void grid_sync(const Args& a) {
    size_t z = 0; asm volatile("" : "+s"(z)); unsigned char* w = a.ws + z;
    XcdBarrier b; b.bar = (unsigned*)(w + WS_CTL) + CW_BAR; b.x = xb_xcc_id(); b.st = (volatile LAS unsigned*)(LDS_BASE + MISC_OFF) + 8;
    xcd_barrier(b);
}

__device__ __forceinline__ void ph_prologue(const Args& args) {
    const Ctx c = make_ctx(args); LAS unsigned char* lds = LDS_BASE; const int lane = c.lane, tid = c.tid;
    {
        LAS unsigned* T = (LAS unsigned*)(lds + c.wave * 8192);
        f32x4 a0[8], b0[8], a1[8], b1[8]; TrItem i0, i1;
        Args la = args; la.ws = c.ws;
        int id = c.gw;
        if (id < IT_TOTAL) { tr_decode(la, id, i0); tr_load(i0, lane, a0, b0); }
        while (id < IT_TOTAL) {
            const int id1 = id + c.NGW;
            if (id1 < IT_TOTAL) { tr_decode(la, id1, i1); tr_load(i1, lane, a1, b1); }
            tr_store(i0, lane, a0, b0, T);
            if (id1 >= IT_TOTAL) break;
            const int id2 = id1 + c.NGW;
            if (id2 < IT_TOTAL) { tr_decode(la, id2, i0); tr_load(i0, lane, a0, b0); }
            tr_store(i1, lane, a1, b1, T);
            id = id2;
        }
    }
    __syncthreads();
    {
        LAS float* Ag = (LAS float*)lds;
        for (int item = c.bx; item < DEPTH * 4 * 16; item += c.G) {
            const int l = item >> 6, g = (item >> 4) & 3, d0 = (item & 15) * 128;
            const float* wg = args.in[I_WPG] + (size_t)(l * 4 + g) * 128 * 128;
            for (int i = tid; i < 128 * 128 / 4; i += NWAVES * 64) *(LAS f32x4*)(Ag + i * 4) = *(const f32x4*)(wg + i * 4);
            __syncthreads();
            const int dl = tid & 127, cq = tid >> 7;
            const float* wb = args.in[I_WBRP] + ((size_t)l * 512 + g * 128) * D + d0 + dl; const float* sc = args.in[I_PSCALE] + l * 512 + g * 128;
            float bv[128];
#pragma unroll
            for (int e = 0; e < 128; ++e) bv[e] = wb[(size_t)e * D] * sc[e];
            bf16* dst = (bf16*)(c.ws + WS_WL + (size_t)l * WL_STRIDE + WL_BR) + (size_t)(d0 + dl) * D + g * 128 + cq * 32;
            for (int c8 = 0; c8 < 4; ++c8) { float o[8];
#pragma unroll
                for (int cc = 0; cc < 8; ++cc) { const LAS float* ar = Ag + (cq * 32 + c8 * 8 + cc) * 128; float s = 0.f;
#pragma unroll
                    for (int e4 = 0; e4 < 32; ++e4) { const f32x4 av = *(const LAS f32x4*)(ar + e4 * 4); s += av[0] * bv[e4 * 4] + av[1] * bv[e4 * 4 + 1] + av[2] * bv[e4 * 4 + 2] + av[3] * bv[e4 * 4 + 3]; }
                    o[cc] = s; }
                u32x4 w; w.x = cvt_pk_bf16(o[0], o[1]); w.y = cvt_pk_bf16(o[2], o[3]); w.z = cvt_pk_bf16(o[4], o[5]); w.w = cvt_pk_bf16(o[6], o[7]);
                *(u32x4*)(dst + c8 * 8) = w; }
            __syncthreads();
        }
    }
    {
        bf16* SC = (bf16*)(c.ws + WS_SC);
        for (int i = c.gw * 64 + lane; i < 256 * D / 4; i += c.NGW * 64) { const int r = i / (D / 4), k = (i - r * (D / 4)) * 4; f32x4 v = {0.f, 0.f, 0.f, 0.f};
            if (r < NMODROWS) { v = r < 4 ? *(const f32x4*)(args.in[I_CP] + (size_t)r * D + k) : *(const f32x4*)(args.in[I_CS] + (size_t)(r - 4) * D + k);
#pragma unroll
                for (int j = 0; j < 4; ++j) v[j] = v[j] * fsigmoid(v[j]); }
            u32x2 w; w.x = cvt_pk_bf16(v[0], v[1]); w.y = cvt_pk_bf16(v[2], v[3]); *(u32x2*)(SC + (size_t)r * D + k) = w; }
        for (int i = c.gw * 64 + lane; i < DEPTH * 128 * 11 * 128; i += c.NGW * 64) { const int c4 = i & 127, j = (i >> 7) % 11, ln = (i >> 7) / 11;
            *(f32x4*)(c.out + O_POOLS + ((size_t)ln * 15 + j) * 512 + c4 * 4) = *(const f32x4*)(args.in[I_SPOOL] + ((size_t)ln * 15 + j + 4) * 512 + c4 * 4); }
    }
}
__device__ __forceinline__ void ph_ada(const Args& args) {
    const Ctx c = make_ctx(args);
    pg8::Gemm g{(const bf16*)(c.ws + WS_SC), (const bf16*)(c.ws + WS_WADA), D}; pg8::TileOrder S; S.init(256, NADA, c.G, c.bx, D);
    EpiAda E{(float*)(c.ws + WS_MOD), args.in[I_BADA]};
    pg8::gemm_phase<EpiAda, pg8::TileOrder, true, true>(LDS_BASE, g, S, E);
}
template <int WSEL, int SH_I, int SC_I, bool FIRST>
__device__ __forceinline__ void ph_norm(const Args& args, int l) {
    const Ctx c = make_ctx(args); const int lane = c.lane;
    float* X = (float*)(c.ws + WS_X); bf16* H = (bf16*)(c.ws + WS_H); float* SSQ = (float*)(c.ws + WS_SSQ);
    const float* modl = (const float*)(c.ws + WS_MOD) + (size_t)l * NADA_L;
    const float* nwp = args.in[WSEL] + (size_t)l * D;
    for (int r = c.gw; r < M; r += c.NGW) {
        const float* xr = (FIRST && l == 0) ? (r < MP ? args.in[I_XP] + (size_t)r * D : args.in[I_XS] + (size_t)(r - MP) * D) : X + (size_t)r * D;
        const float* mr = modl + (size_t)mod_row(r) * NADA;
        f32x4 v[8]; float s = 0.f;
#pragma unroll
        for (int j = 0; j < 8; ++j) { v[j] = *(const f32x4*)(xr + 4 * lane + 256 * j); s += (v[j][0] * v[j][0] + v[j][1] * v[j][1]) + (v[j][2] * v[j][2] + v[j][3] * v[j][3]); }
        const float rstd = 1.0f / sqrtf(wave_sum(s) * (1.0f / D) + EPS);
#pragma unroll
        for (int j = 0; j < 8; ++j) { const int k = 4 * lane + 256 * j;
            if (FIRST && l == 0) *(f32x4*)(X + (size_t)r * D + k) = v[j];
            const f32x4 nw = *(const f32x4*)(nwp + k), sc = *(const f32x4*)(mr + SC_I * D + k), sh = *(const f32x4*)(mr + SH_I * D + k);
            const f32x4 h = (v[j] * rstd) * nw * (1.0f + sc) + sh;
            u32x2 w; w.x = cvt_pk_bf16(h[0], h[1]); w.y = cvt_pk_bf16(h[2], h[3]); *(u32x2*)(H + (size_t)r * D + k) = w; }
        if (FIRST && lane == 0) SSQ[r] = 0.f;
    }
}
__device__ __forceinline__ void ph_inproj(const Args& args, int l) {
    const Ctx c = make_ctx(args); unsigned char* ws = c.ws;
    pg8::Gemm g{(const bf16*)(ws + WS_H), (const bf16*)(ws + WS_WL + (size_t)l * WL_STRIDE + WL_IN), D}; pg8::TileOrder S; S.init(M, NIN, c.G, c.bx, D);
    EpiIn E{(float*)(ws + WS_P), (bf16*)(ws + WS_Z), (bf16*)(ws + WS_BC), (bf16*)(ws + WS_GU), (bf16*)(ws + WS_GV), (bf16*)(ws + WS_G), (float*)(ws + WS_SSQ), c.out, l};
    pg8::gemm_phase<EpiIn, pg8::TileOrder, true, true>(LDS_BASE, g, S, E);
}
__device__ __forceinline__ void ph_mixers(const Args& args, int l) {
    const Ctx c = make_ctx(args); unsigned char* ws = c.ws; LAS unsigned char* lds = LDS_BASE; const int lane = c.lane, tid = c.tid, wave = c.wave; float* out = c.out;
    const float* P = (const float*)(ws + WS_P); const bf16* Z = (const bf16*)(ws + WS_Z); const bf16* BC = (const bf16*)(ws + WS_BC); const bf16* GU = (const bf16*)(ws + WS_GU); const bf16* GV = (const bf16*)(ws + WS_GV);
    bf16* BR = (bf16*)(ws + WS_BR); const float* SSQ = (const float*)(ws + WS_SSQ);
    const float* sgn = args.in[I_SGUN] + l * 512;
    {
        LAS bf16* VT = (LAS bf16*)lds;
        for (int un = c.bx; un < 256; un += c.G) {
            const int ck = un >> 2, g = un & 3, r0 = ck * 128, b = ck >> 4; const bool lastck = (ck & 15) == 15;
            {   const int j = tid >> 2, cb = (tid & 3) * 32; const int r = r0 + j;
                const float rs = 1.0f / sqrtf(SSQ[r] * (1.0f / 512.0f) + EPS);
#pragma unroll
                for (int q = 0; q < 4; ++q) { const int cc = cb + q * 8; const u32x4 raw = *(const u32x4*)(GV + (size_t)r * 512 + g * 128 + cc);
                    const f32x4 n0 = *(const f32x4*)(sgn + g * 128 + cc), n1 = *(const f32x4*)(sgn + g * 128 + cc + 4);
                    float vn[8] = {bf_lo(raw.x) * rs * n0[0], bf_hi(raw.x) * rs * n0[1], bf_lo(raw.y) * rs * n0[2], bf_hi(raw.y) * rs * n0[3], bf_lo(raw.z) * rs * n1[0], bf_hi(raw.z) * rs * n1[1], bf_lo(raw.w) * rs * n1[2], bf_hi(raw.w) * rs * n1[3]};
                    if (lastck) { float* o = out + O_VP + ((size_t)(l * 4 + b) * 128 + j) * 512 + g * 128 + cc; *(f32x4*)o = (f32x4){vn[0], vn[1], vn[2], vn[3]}; *(f32x4*)(o + 4) = (f32x4){vn[4], vn[5], vn[6], vn[7]}; }
#pragma unroll
                    for (int e = 0; e < 8; e += 2) { const unsigned pk = cvt_pk_bf16(vn[e], vn[e + 1]); VT[(cc + e) * 136 + j] = (bf16)(pk & 0xffffu); VT[(cc + e + 1) * 136 + j] = (bf16)(pk >> 16); } }
            }
            LDS_WAIT(); __syncthreads();
            {   const int fr = lane & 15, fq = lane >> 4; const int i = wave * 16 + fr;
                f32x4 acc[8];
#pragma unroll
                for (int nb = 0; nb < 8; ++nb) acc[nb] = (f32x4){0.f, 0.f, 0.f, 0.f};
                const float* wrow = args.in[I_WSGU] + ((size_t)(l * 4 + g) * 128 + i) * 128;
#pragma unroll
                for (int kb = 0; kb < 4; ++kb) {
                    if (32 * kb <= wave * 16 + 15) {
                        const int j0 = 32 * kb + 8 * fq; const f32x4 w0 = *(const f32x4*)(wrow + j0), w1 = *(const f32x4*)(wrow + j0 + 4);
                        float wv[8] = {w0[0], w0[1], w0[2], w0[3], w1[0], w1[1], w1[2], w1[3]};
#pragma unroll
                        for (int e = 0; e < 8; ++e) wv[e] = (j0 + e <= i) ? wv[e] : 0.f;
                        u32x4 wp; wp.x = cvt_pk_bf16(wv[0], wv[1]); wp.y = cvt_pk_bf16(wv[2], wv[3]); wp.z = cvt_pk_bf16(wv[4], wv[5]); wp.w = cvt_pk_bf16(wv[6], wv[7]);
                        const bf16x8 wf = __builtin_bit_cast(bf16x8, wp);
#pragma unroll
                        for (int nb = 0; nb < 8; ++nb) { const bf16x8 vf = *(const LAS bf16x8*)(VT + (16 * nb + fr) * 136 + j0);
                            acc[nb] = __builtin_amdgcn_mfma_f32_16x16x32_bf16(vf, wf, acc[nb], 0, 0, 0); }
                    }
                }
                const float bi = args.in[I_BSGU][(l * 4 + g) * 128 + i]; const int r = r0 + i;
#pragma unroll
                for (int nb = 0; nb < 8; ++nb) { const int cc = g * 128 + 16 * nb + 4 * fq; const u32x2 gu = *(const u32x2*)(GU + (size_t)r * 512 + cc);
                    const f32x4 o = {(acc[nb][0] + bi) * bf_lo(gu.x), (acc[nb][1] + bi) * bf_hi(gu.x), (acc[nb][2] + bi) * bf_lo(gu.y), (acc[nb][3] + bi) * bf_hi(gu.y)};
                    u32x2 w; w.x = cvt_pk_bf16(o[0], o[1]); w.y = cvt_pk_bf16(o[2], o[3]); *(u32x2*)(BR + (size_t)r * D + 1536 + cc) = w; }
            }
            __syncthreads();
        }
    }
    for (int task = c.gw; task < M + 128; task += c.NGW) {
        if (task < M) {
            const int r = task; const bool samp = r >= MP; const int t = samp ? ((r - MP) & 3) : (r & (TP - 1)); const int n = samp ? ((r - MP) >> 2) : 0;
            {
                const int c0 = 8 * lane, g = lane >> 4, w = 2 << g;
                const f32x4 p0 = *(const f32x4*)(P + (size_t)r * 512 + c0), p1 = *(const f32x4*)(P + (size_t)r * 512 + c0 + 4);
                f32x4 s0 = p0, s1 = p1;
                for (int j = 1; j < 16; ++j) { if (j < w) { const int tj = t - j;
                    if (tj >= 0) { const float* q = P + (size_t)(r - j) * 512 + c0; s0 += *(const f32x4*)q; s1 += *(const f32x4*)(q + 4); }
                    else if (samp) { const float* q = args.in[I_SPOOL] + ((size_t)(l * 128 + n) * 15 + 15 + tj) * 512 + c0; s0 += *(const f32x4*)q; s1 += *(const f32x4*)(q + 4); } } }
                const float inv = 1.0f / (float)(samp ? w : (t + 1 < w ? t + 1 : w));
                const f32x4 d0 = s0 * inv - p0, d1 = s1 * inv - p1;
                u32x4 wv; wv.x = cvt_pk_bf16(d0[0], d0[1]); wv.y = cvt_pk_bf16(d0[2], d0[3]); wv.z = cvt_pk_bf16(d1[0], d1[1]); wv.w = cvt_pk_bf16(d1[2], d1[3]);
                *(u32x4*)(BR + (size_t)r * D + c0) = wv;
            }
#pragma unroll
            for (int q = 0; q < 2; ++q) {
                const int ch = (q * 64 + lane) * 8; const float* wc = args.in[I_WCONV] + (size_t)l * 3 * 1024 + ch;
                f32x4 a0 = {0.f, 0.f, 0.f, 0.f}, a1 = {0.f, 0.f, 0.f, 0.f};
#pragma unroll
                for (int k = 0; k < 3; ++k) { const int tk = t - 2 + k; f32x4 z0 = {0.f, 0.f, 0.f, 0.f}, z1 = {0.f, 0.f, 0.f, 0.f};
                    if (tk >= 0) { const u32x4 raw = *(const u32x4*)(Z + (size_t)(r - 2 + k) * 1024 + ch); z0 = (f32x4){bf_lo(raw.x), bf_hi(raw.x), bf_lo(raw.y), bf_hi(raw.y)}; z1 = (f32x4){bf_lo(raw.z), bf_hi(raw.z), bf_lo(raw.w), bf_hi(raw.w)}; }
                    else if (samp) { const float* qz = args.in[I_SCONV] + ((size_t)(l * 128 + n) * 2 + 2 + tk) * 1024 + ch; z0 = *(const f32x4*)qz; z1 = *(const f32x4*)(qz + 4); }
                    a0 += *(const f32x4*)(wc + k * 1024) * z0; a1 += *(const f32x4*)(wc + k * 1024 + 4) * z1; }
                const u32x4 braw = *(const u32x4*)(BC + (size_t)r * 1024 + ch);
                const f32x4 o0 = a0 * (f32x4){bf_lo(braw.x), bf_hi(braw.x), bf_lo(braw.y), bf_hi(braw.y)}, o1 = a1 * (f32x4){bf_lo(braw.z), bf_hi(braw.z), bf_lo(braw.w), bf_hi(braw.w)};
                u32x4 wv; wv.x = cvt_pk_bf16(o0[0], o0[1]); wv.y = cvt_pk_bf16(o0[2], o0[3]); wv.z = cvt_pk_bf16(o1[0], o1[1]); wv.w = cvt_pk_bf16(o1[2], o1[3]);
                *(u32x4*)(BR + (size_t)r * D + 512 + ch) = wv;
            }
        } else {
            const int n = task - M, r0 = MP + 4 * n, c0 = 8 * lane, g = lane >> 4;
            const f32x4 n0 = *(const f32x4*)(sgn + c0), n1 = *(const f32x4*)(sgn + c0 + 4);
            float vn[4][8];
#pragma unroll
            for (int j = 0; j < 4; ++j) { const float rs = 1.0f / sqrtf(SSQ[r0 + j] * (1.0f / 512.0f) + EPS); const u32x4 raw = *(const u32x4*)(GV + (size_t)(r0 + j) * 512 + c0);
                vn[j][0] = bf_lo(raw.x) * rs * n0[0]; vn[j][1] = bf_hi(raw.x) * rs * n0[1]; vn[j][2] = bf_lo(raw.y) * rs * n0[2]; vn[j][3] = bf_hi(raw.y) * rs * n0[3];
                vn[j][4] = bf_lo(raw.z) * rs * n1[0]; vn[j][5] = bf_hi(raw.z) * rs * n1[1]; vn[j][6] = bf_lo(raw.w) * rs * n1[2]; vn[j][7] = bf_hi(raw.w) * rs * n1[3];
                float* o = out + O_VS + ((size_t)(l * 128 + n) * 4 + j) * 512 + c0; *(f32x4*)o = (f32x4){vn[j][0], vn[j][1], vn[j][2], vn[j][3]}; *(f32x4*)(o + 4) = (f32x4){vn[j][4], vn[j][5], vn[j][6], vn[j][7]}; }
#pragma unroll
            for (int i = 0; i < 4; ++i) { const f32x4 wr4 = *(const f32x4*)(args.in[I_WSGU] + ((size_t)(l * 4 + g) * 128 + i) * 128); const float bi = args.in[I_BSGU][(l * 4 + g) * 128 + i];
                const u32x4 gu = *(const u32x4*)(GU + (size_t)(r0 + i) * 512 + c0); const float guf[8] = {bf_lo(gu.x), bf_hi(gu.x), bf_lo(gu.y), bf_hi(gu.y), bf_lo(gu.z), bf_hi(gu.z), bf_lo(gu.w), bf_hi(gu.w)};
                float o[8];
#pragma unroll
                for (int e = 0; e < 8; ++e) { float s = bi;
#pragma unroll
                    for (int j = 0; j < 4; ++j) if (j <= i) s += wr4[j] * vn[j][e];
                    o[e] = s * guf[e]; }
                u32x4 wv; wv.x = cvt_pk_bf16(o[0], o[1]); wv.y = cvt_pk_bf16(o[2], o[3]); wv.z = cvt_pk_bf16(o[4], o[5]); wv.w = cvt_pk_bf16(o[6], o[7]);
                *(u32x4*)(BR + (size_t)(r0 + i) * D + 1536 + c0) = wv; }
        }
    }
}
__device__ __forceinline__ void ph_merge(const Args& args, int l) {
    const Ctx c = make_ctx(args); unsigned char* ws = c.ws;
    pg8::Gemm g{(const bf16*)(ws + WS_BR), (const bf16*)(ws + WS_WL + (size_t)l * WL_STRIDE + WL_BR), D}; pg8::TileOrder S; S.init(M, D, c.G, c.bx, D);
    S.nseg = 3;
    EpiMerge E{(const bf16*)(ws + WS_G), (bf16*)(ws + WS_MG)};
    pg8::gemm_phase<EpiMerge, pg8::TileOrder, true, true>(LDS_BASE, g, S, E);
}
__device__ __forceinline__ void ph_out(const Args& args, int l) {
    const Ctx c = make_ctx(args); unsigned char* ws = c.ws;
    pg8::Gemm g{(const bf16*)(ws + WS_MG), (const bf16*)(ws + WS_WL + (size_t)l * WL_STRIDE + WL_OUT), D}; pg8::TileOrder S; S.init(M, D, c.G, c.bx, D);
    EpiRes E{(float*)(ws + WS_X), (const float*)(ws + WS_MOD) + (size_t)l * NADA_L + 2 * D};
    pg8::gemm_phase<EpiRes, pg8::TileOrder, true, true>(LDS_BASE, g, S, E);
}
__device__ __forceinline__ void ph_ff1(const Args& args, int l) {
    const Ctx c = make_ctx(args); unsigned char* ws = c.ws;
    pg8::Gemm g{(const bf16*)(ws + WS_H), (const bf16*)(ws + WS_WL + (size_t)l * WL_STRIDE + WL_FF1), D}; pg8::TileOrder S; S.init(M, DFF, c.G, c.bx, D);
    EpiRelu2 E{(bf16*)(ws + WS_ACT)};
    pg8::gemm_phase<EpiRelu2, pg8::TileOrder, true, true>(LDS_BASE, g, S, E);
}
__device__ __forceinline__ void ph_ff2(const Args& args, int l) {
    const Ctx c = make_ctx(args); unsigned char* ws = c.ws;
    pg8::Gemm g{(const bf16*)(ws + WS_ACT), (const bf16*)(ws + WS_WL + (size_t)l * WL_STRIDE + WL_FF2), DFF}; pg8::TileOrder S; S.init(M, D, c.G, c.bx, DFF);
    EpiRes E{(float*)(ws + WS_X), (const float*)(ws + WS_MOD) + (size_t)l * NADA_L + 5 * D};
    pg8::gemm_phase<EpiRes, pg8::TileOrder, true, true>(LDS_BASE, g, S, E);
}
__device__ __forceinline__ void ph_final(const Args& args) {
    const Ctx c = make_ctx(args); const int lane = c.lane;
    const float* X = (const float*)(c.ws + WS_X); const float* fw = args.in[I_FNORM];
    for (int r = c.gw; r < M; r += c.NGW) {
        const float* xr = X + (size_t)r * D; f32x4 v[8]; float s = 0.f;
#pragma unroll
        for (int j = 0; j < 8; ++j) { v[j] = *(const f32x4*)(xr + 4 * lane + 256 * j); s += (v[j][0] * v[j][0] + v[j][1] * v[j][1]) + (v[j][2] * v[j][2] + v[j][3] * v[j][3]); }
        const float rstd = 1.0f / sqrtf(wave_sum(s) * (1.0f / D) + EPS);
        float* o = c.out + (size_t)r * D;
#pragma unroll
        for (int j = 0; j < 8; ++j) { const int k = 4 * lane + 256 * j; *(f32x4*)(o + k) = (v[j] * rstd) * *(const f32x4*)(fw + k); }
    }
}

#ifndef DBGM
#define DBGM 0xffffffffu
#endif
__global__ void __launch_bounds__(NWAVES * 64, 2) mk_fwd(Args args) {
    {   LAS unsigned char* lds = LDS_BASE;
        for (int u = threadIdx.x; u < (LDS_BYTES - RING_BYTES) / 4; u += NWAVES * 64) ((LAS unsigned*)(lds + RING_BYTES))[u] = 0u;
        __syncthreads();
        if (!MK_SPLIT) (void)xcd_barrier_post((unsigned*)(args.ws + WS_CTL) + CW_BAR, (volatile LAS unsigned*)(lds + MISC_OFF) + 8);
    }
    const int lo = args.ph_lo, hi = args.ph_hi;
#define IN(k) (lo <= (k) && (k) < hi)
#define SEAM(k) do { if (IN(k) && IN((k) + 1)) grid_sync(args); } while (0)
    if ((DBGM & 1) && IN(0)) ph_prologue(args);
    SEAM(0);
    if ((DBGM & 2) && IN(1)) ph_ada(args);
    SEAM(1);
    for (int l = 0; l < DEPTH; ++l) {
        const int pb = 2 + 8 * l;
        if ((DBGM & 4) && IN(pb + 0)) ph_norm<I_NORM1, 0, 1, true>(args, l);
        SEAM(pb + 0);
        if ((DBGM & 8) && IN(pb + 1)) ph_inproj(args, l);
        SEAM(pb + 1);
        if ((DBGM & 16) && IN(pb + 2)) ph_mixers(args, l);
        SEAM(pb + 2);
        if ((DBGM & 32) && IN(pb + 3)) ph_merge(args, l);
        SEAM(pb + 3);
        if ((DBGM & 64) && IN(pb + 4)) ph_out(args, l);
        SEAM(pb + 4);
        if ((DBGM & 128) && IN(pb + 5)) ph_norm<I_NORM2, 3, 4, false>(args, l);
        SEAM(pb + 5);
        if ((DBGM & 256) && IN(pb + 6)) ph_ff1(args, l);
        SEAM(pb + 6);
        if ((DBGM & 512) && IN(pb + 7)) ph_ff2(args, l);
        SEAM(pb + 7);
    }
    if ((DBGM & 1024) && IN(34)) ph_final(args);
#undef IN
#undef SEAM
}

constexpr int NPHASES = 35;
extern "C" void kernel_launch(void* const* d_in, const int* in_sizes, int n_in, void* d_out, int out_size, void* d_ws, size_t ws_size, hipStream_t stream) {
    static int grid = 0;
    if (grid == 0) {
        if (n_in != 24 || (size_t)out_size != O_END || ws_size < WS_END) { fprintf(stderr, "kernel_launch: unexpected shapes (n_in %d out %d ws %zu, need %zu)\n", n_in, out_size, ws_size, (size_t)WS_END); grid = -1; return; }
        int dev = 0, cus = 0, per_cu = 0;
        if (hipGetDevice(&dev) != hipSuccess || hipDeviceGetAttribute(&cus, hipDeviceAttributeMultiprocessorCount, dev) != hipSuccess) { grid = -1; return; }
        if (hipFuncSetAttribute((const void*)mk_fwd, hipFuncAttributeMaxDynamicSharedMemorySize, LDS_BYTES) != hipSuccess) { fprintf(stderr, "kernel_launch: hipFuncSetAttribute failed\n"); grid = -1; return; }
        if (hipOccupancyMaxActiveBlocksPerMultiprocessor(&per_cu, (const void*)mk_fwd, NWAVES * 64, LDS_BYTES) != hipSuccess || per_cu < 1) { fprintf(stderr, "kernel_launch: occupancy query says %d blocks per CU\n", per_cu); }
        (void)hipGetLastError();
        grid = cus;
    }
    if (grid < 0) return;
    if (hipMemsetAsync((char*)d_ws + WS_CTL, 0, CTL_ZERO_BYTES, stream) != hipSuccess) return;
    Args a{};
    for (int i = 0; i < 24; ++i) a.in[i] = (const float*)d_in[i];
    a.out = (float*)d_out; a.ws = (unsigned char*)d_ws;
#if MK_SPLIT
    for (int p = 0; p < NPHASES; ++p) { a.ph_lo = p; a.ph_hi = p + 1; hipLaunchKernelGGL(mk_fwd, dim3(grid), dim3(NWAVES * 64), LDS_BYTES, stream, a); }
#else
    a.ph_lo = 0; a.ph_hi = NPHASES;
    hipLaunchKernelGGL(mk_fwd, dim3(grid), dim3(NWAVES * 64), LDS_BYTES, stream, a);
#endif
    const hipError_t le = hipPeekAtLastError();
    if (le != hipSuccess) fprintf(stderr, "kernel_launch: launch failed: %s\n", hipGetErrorName(le));
}
```
